# Optimizing an MI355X kernel written in HIP

```python
import math
import jax, jax.numpy as jnp
from jax import lax
import numpy as np

D_MODEL = 2048
BATCH = 4
SEQ = 2048
DEPTH = 1

MIX_WIDTH = D_MODEL
DA_WIDTH = MIX_WIDTH // 2
RET_WIDTH = MIX_WIDTH - DA_WIDTH
DA_HEAD_DIM = 64
DA_V_DIM = 2 * DA_HEAD_DIM
DA_HEADS = DA_WIDTH // DA_V_DIM
RET_HEADS = 4
RET_V_DIM = RET_WIDTH // RET_HEADS
RET_K_DIM = RET_V_DIM // 2
RET_CHUNK = 128
Q_BLOCK = 128
ROPE_THETA = 10000.0
PLE_DIM = 256
N_GROUPS = 4
EXPERTS_PER_GROUP = 8
N_EXPERTS = N_GROUPS * EXPERTS_PER_GROUP
TOP_K = 2
EXPERT_FF = D_MODEL // 4
DEEPNORM_ALPHA = (2 * DEPTH) ** 0.25
DEEPNORM_BETA = (8 * DEPTH) ** -0.25
LN_EPS = 1e-5
SPLITS = (DA_HEADS * 2 * DA_HEAD_DIM, DA_HEADS * 2 * DA_HEAD_DIM, DA_HEADS * DA_V_DIM,
          RET_HEADS * RET_K_DIM, RET_HEADS * RET_K_DIM, RET_HEADS * RET_V_DIM, RET_WIDTH)
IN_WIDTH = sum(SPLITS)

kernel_name = "hymba_diffattn_retnet_hiermoe_deepnorm_ple"


def _layer_norm(x, g, b):
    xf = x.astype(jnp.float32)
    mu = jnp.mean(xf, -1, keepdims=True)
    var = jnp.mean(jnp.square(xf - mu), -1, keepdims=True)
    y = (xf - mu) * lax.rsqrt(var + LN_EPS) * g.astype(jnp.float32) + b.astype(jnp.float32)
    return y.astype(x.dtype)


def _rope(t, positions):
    d = t.shape[-1]
    inv = jnp.power(ROPE_THETA, -jnp.arange(0, d, 2, dtype=jnp.float32) / d)
    ang = positions.astype(jnp.float32)[..., None] * inv
    ang = ang.reshape(ang.shape[:2] + (1,) * (t.ndim - 3) + ang.shape[-1:])
    cos, sin = jnp.cos(ang), jnp.sin(ang)
    t1, t2 = jnp.split(t.astype(jnp.float32), 2, axis=-1)
    return jnp.concatenate([t1 * cos - t2 * sin, t2 * cos + t1 * sin], -1).astype(t.dtype)


def _diff_attention(q, k, v, lam, subln_w, lam_init):
    B, S, H, _, dh = q.shape
    dv = v.shape[-1]
    nb = S // Q_BLOCK
    scale = dh ** -0.5
    qb = q.reshape(B, nb, Q_BLOCK, H, 2, dh).transpose(1, 0, 3, 4, 2, 5)
    kt = k.transpose(0, 2, 3, 1, 4)
    vt = v.transpose(0, 2, 1, 3)
    kpos = jnp.arange(S)
    neg = jnp.finfo(jnp.float32).min

    def block(args):
        qblk, i = args
        s = jnp.einsum('bhtqd,bhtkd->bhtqk', qblk, kt).astype(jnp.float32) * scale
        qpos = i * Q_BLOCK + jnp.arange(Q_BLOCK)
        s = jnp.where(kpos[None, :] <= qpos[:, None], s, neg)
        a = jax.nn.softmax(s, axis=-1)
        a = a[:, :, 0] - lam * a[:, :, 1]
        return jnp.einsum('bhqk,bhkd->bhqd', a.astype(v.dtype), vt)

    o = lax.map(block, (qb, jnp.arange(nb)))
    o = o.transpose(1, 0, 3, 2, 4).reshape(B, S, H, dv).astype(jnp.float32)
    o = o * lax.rsqrt(jnp.mean(jnp.square(o), -1, keepdims=True) + LN_EPS)
    o = o * subln_w.astype(jnp.float32) * (1.0 - lam_init)
    return o.reshape(B, S, H * dv).astype(v.dtype)


def _retention(q, k, v, g):
    B, S, H, dk = q.shape
    dv = v.shape[-1]
    C = RET_CHUNK
    nc = S // C
    k = k * (dk ** -0.5)
    to_chunks = lambda t: t.reshape(B, nc, C, H, t.shape[-1]).transpose(0, 3, 1, 2, 4)
    qc, kc, vc = to_chunks(q), to_chunks(k), to_chunks(v)
    lg = jnp.log(1.0 - jnp.power(2.0, -5.0 - jnp.arange(H, dtype=jnp.float32)))
    n = jnp.arange(C, dtype=jnp.float32)
    rel = n[:, None] - n[None, :]
    decay = jnp.where(rel >= 0, jnp.exp(rel[None] * lg[:, None, None]), 0.0)
    inner = jnp.einsum('bhcnd,bhcmd->bhcnm', qc, kc).astype(jnp.float32) * decay[None, :, None]
    inner_o = jnp.einsum('bhcnm,bhcme->bhcne', inner, vc.astype(jnp.float32))
    zeta = jnp.exp((C - 1.0 - n)[None] * lg[:, None])
    xi = jnp.exp((n + 1.0)[None] * lg[:, None])
    kv = jnp.einsum('bhcmd,bhcme->bhcde',
                    kc.astype(jnp.float32) * zeta[None, :, None, :, None],
                    vc.astype(jnp.float32))
    chunk_decay = jnp.exp(C * lg)[None, :, None, None]

    def step(state, kv_c):
        return chunk_decay * state + kv_c, state

    _, r_prev = lax.scan(step, jnp.zeros((B, H, dk, dv), jnp.float32),
                         kv.transpose(2, 0, 1, 3, 4))
    cross = jnp.einsum('bhcnd,cbhde->bhcne', qc.astype(jnp.float32), r_prev)
    y = inner_o + cross * xi[None, :, None, :, None]
    y = y.transpose(0, 2, 3, 1, 4).reshape(B, S, H, dv)
    mu = jnp.mean(y, -1, keepdims=True)
    var = jnp.mean(jnp.square(y - mu), -1, keepdims=True)
    y = ((y - mu) * lax.rsqrt(var + LN_EPS)).reshape(B, S, H * dv)
    return (jax.nn.silu(g.astype(jnp.float32)) * y).astype(v.dtype)


def _hybrid_mixer(x, positions, w_in, w_out, lq1, lk1, lq2, lk2, subln_w, lam_init):
    B, S, _ = x.shape
    q_da, k_da, v_da, q_r, k_r, v_r, g_r = jnp.split(x @ w_in, np.cumsum(SPLITS)[:-1], axis=-1)
    q_da = _rope(q_da.reshape(B, S, DA_HEADS, 2, DA_HEAD_DIM), positions)
    k_da = _rope(k_da.reshape(B, S, DA_HEADS, 2, DA_HEAD_DIM), positions)
    v_da = v_da.reshape(B, S, DA_HEADS, DA_V_DIM)
    f32 = jnp.float32
    lam = (jnp.exp(jnp.sum(lq1.astype(f32) * lk1.astype(f32)))
           - jnp.exp(jnp.sum(lq2.astype(f32) * lk2.astype(f32))) + lam_init)
    o_da = _diff_attention(q_da, k_da, v_da, lam, subln_w, lam_init)
    q_r = _rope(q_r.reshape(B, S, RET_HEADS, RET_K_DIM), positions)
    k_r = _rope(k_r.reshape(B, S, RET_HEADS, RET_K_DIM), positions)
    v_r = v_r.reshape(B, S, RET_HEADS, RET_V_DIM)
    o_r = _retention(q_r, k_r, v_r, g_r)
    return jnp.concatenate([o_da, o_r], axis=-1) @ w_out


def _hier_moe(x, w_rg, b_rg, w_re, b_re, w_gate, w_up, w_down):
    B, S, D = x.shape
    xf = x.reshape(B * S, D)
    gl = (xf @ w_rg).astype(jnp.float32) + b_rg.astype(jnp.float32)
    gp = jax.nn.softmax(gl, axis=-1)
    g_idx = jnp.argmax(gl, axis=-1)
    g_w = jnp.take_along_axis(gp, g_idx[:, None], axis=1)
    el = ((xf @ w_re).astype(jnp.float32) + b_re.astype(jnp.float32)).reshape(-1, N_GROUPS, EXPERTS_PER_GROUP)
    el = jnp.take_along_axis(el, g_idx[:, None, None], axis=1)[:, 0]
    tv, ti = lax.top_k(el, TOP_K)
    fw = jax.nn.softmax(tv, axis=-1) * g_w
    eid = g_idx[:, None] * EXPERTS_PER_GROUP + ti
    combine = jnp.sum(jax.nn.one_hot(eid, N_EXPERTS, dtype=jnp.float32) * fw[..., None], axis=1)

    def expert_step(y, params):
        wg, wu, wd, c = params
        h = jax.nn.silu(xf @ wg) * (xf @ wu)
        return y + (h @ wd).astype(jnp.float32) * c[:, None], None

    y, _ = lax.scan(expert_step, jnp.zeros(xf.shape, jnp.float32),
                    (w_gate, w_up, w_down, combine.T))
    return y.reshape(B, S, D).astype(x.dtype)


def setup_inputs(seed: int = 0) -> dict:
    key = jax.random.key(seed)
    ks = jax.random.split(key, 24)
    nrm = lambda k, shape, s: jax.random.normal(k, shape, jnp.float32) * s
    beta = DEEPNORM_BETA
    col_scale = jnp.concatenate([
        jnp.ones((SPLITS[0] + SPLITS[1],), jnp.float32),
        jnp.full((SPLITS[2],), beta, jnp.float32),
        jnp.ones((SPLITS[3] + SPLITS[4],), jnp.float32),
        jnp.full((SPLITS[5],), beta, jnp.float32),
        jnp.ones((SPLITS[6],), jnp.float32)])
    return {
        "x": nrm(ks[0], (BATCH, SEQ, D_MODEL), 1.0),
        "p": nrm(ks[1], (DEPTH, BATCH, SEQ, PLE_DIM), 1.0),
        "positions": jnp.broadcast_to(jnp.arange(SEQ, dtype=jnp.int32), (BATCH, SEQ)),
        "w_in": nrm(ks[2], (DEPTH, D_MODEL, IN_WIDTH), D_MODEL ** -0.5) * col_scale,
        "w_out": nrm(ks[3], (DEPTH, MIX_WIDTH, D_MODEL), beta * MIX_WIDTH ** -0.5),
        "da_lambda_q1": nrm(ks[4], (DEPTH, DA_HEAD_DIM), 0.1),
        "da_lambda_k1": nrm(ks[5], (DEPTH, DA_HEAD_DIM), 0.1),
        "da_lambda_q2": nrm(ks[6], (DEPTH, DA_HEAD_DIM), 0.1),
        "da_lambda_k2": nrm(ks[7], (DEPTH, DA_HEAD_DIM), 0.1),
        "da_subln_w": 1.0 + nrm(ks[8], (DEPTH, DA_V_DIM), 0.02),
        "ln1_g": 1.0 + nrm(ks[9], (DEPTH, D_MODEL), 0.02),
        "ln1_b": nrm(ks[10], (DEPTH, D_MODEL), 0.02),
        "w_router_group": nrm(ks[11], (DEPTH, D_MODEL, N_GROUPS), D_MODEL ** -0.5),
        "b_router_group": nrm(ks[12], (DEPTH, N_GROUPS), 0.01),
        "w_router_expert": nrm(ks[13], (DEPTH, D_MODEL, N_EXPERTS), D_MODEL ** -0.5),
        "b_router_expert": nrm(ks[14], (DEPTH, N_EXPERTS), 0.01),
        "w_exp_gate": nrm(ks[15], (DEPTH, N_EXPERTS, D_MODEL, EXPERT_FF), D_MODEL ** -0.5),
        "w_exp_up": nrm(ks[16], (DEPTH, N_EXPERTS, D_MODEL, EXPERT_FF), D_MODEL ** -0.5),
        "w_exp_down": nrm(ks[17], (DEPTH, N_EXPERTS, EXPERT_FF, D_MODEL), beta * EXPERT_FF ** -0.5),
        "ln2_g": 1.0 + nrm(ks[18], (DEPTH, D_MODEL), 0.02),
        "ln2_b": nrm(ks[19], (DEPTH, D_MODEL), 0.02),
        "w_ple_gate": nrm(ks[20], (DEPTH, D_MODEL, D_MODEL), D_MODEL ** -0.5),
        "w_ple_proj": nrm(ks[21], (DEPTH, PLE_DIM, D_MODEL), PLE_DIM ** -0.5),
    }


def reference(x, p, positions, w_in, w_out, da_lambda_q1, da_lambda_k1, da_lambda_q2,
              da_lambda_k2, da_subln_w, ln1_g, ln1_b, w_router_group, b_router_group,
              w_router_expert, b_router_expert, w_exp_gate, w_exp_up, w_exp_down,
              ln2_g, ln2_b, w_ple_gate, w_ple_proj):
    for l in range(DEPTH):
        lam_init = 0.8 - 0.6 * math.exp(-0.3 * l)
        h = _hybrid_mixer(x, positions, w_in[l], w_out[l], da_lambda_q1[l], da_lambda_k1[l],
                          da_lambda_q2[l], da_lambda_k2[l], da_subln_w[l], lam_init)
        x = _layer_norm(DEEPNORM_ALPHA * x + h, ln1_g[l], ln1_b[l])
        m = _hier_moe(x, w_router_group[l], b_router_group[l], w_router_expert[l],
                      b_router_expert[l], w_exp_gate[l], w_exp_up[l], w_exp_down[l])
        x = _layer_norm(DEEPNORM_ALPHA * x + m, ln2_g[l], ln2_b[l])
        x = x + jax.nn.sigmoid(x @ w_ple_gate[l]) * (p[l] @ w_ple_proj[l])
    return x
```

```cpp
#include <hip/hip_runtime.h>
#include <hip/hip_bf16.h>
#include <cstdio>
#include <cstdint>
#include <cmath>

#ifndef MK_N_LAUNCHES
#define MK_N_LAUNCHES 1
#endif

#define LAS __attribute__((address_space(3)))
#define GAS __attribute__((address_space(1)))
typedef unsigned short bf16_t;
typedef short bf16x8 __attribute__((ext_vector_type(8)));
typedef short s16x4 __attribute__((ext_vector_type(4)));
typedef float f32x4 __attribute__((ext_vector_type(4)));
typedef float f32x2 __attribute__((ext_vector_type(2)));
typedef float f32x16 __attribute__((ext_vector_type(16)));
typedef unsigned u32x4 __attribute__((ext_vector_type(4)));
typedef unsigned u32x2 __attribute__((ext_vector_type(2)));

constexpr int NTOK = 8192, DM = 2048, SEQ = 2048, NBATCH = 4, INW = 6144, PLED = 256, NEXP = 32, FF = 512;
constexpr float ALPHA = 1.189207115002721f;
constexpr float LN_EPS = 1e-5f;
constexpr float LAM_INIT = 0.2f;
constexpr int MAXMT = 96;
constexpr int NPHASE = 10;

__device__ __forceinline__ unsigned cvt_pk_bf16(float lo, float hi) { unsigned r; asm volatile("v_cvt_pk_bf16_f32 %0, %1, %2" : "=v"(r) : "v"(lo), "v"(hi)); return r; }
__device__ __forceinline__ float bf_lo(unsigned w) { return __uint_as_float(w << 16); }
__device__ __forceinline__ float bf_hi(unsigned w) { return __uint_as_float(w & 0xffff0000u); }
__device__ __forceinline__ u32x4 pack8f(f32x4 a, f32x4 b) { u32x4 w; w.x = cvt_pk_bf16(a[0], a[1]); w.y = cvt_pk_bf16(a[2], a[3]); w.z = cvt_pk_bf16(b[0], b[1]); w.w = cvt_pk_bf16(b[2], b[3]); return w; }
__device__ __forceinline__ float silu_f(float v) { return v * __builtin_amdgcn_rcpf(1.0f + __builtin_amdgcn_exp2f(-1.4426950408889634f * v)); }
__device__ __forceinline__ float sigmoid_f(float v) { return __builtin_amdgcn_rcpf(1.0f + __builtin_amdgcn_exp2f(-1.4426950408889634f * v)); }
__device__ __forceinline__ float wave_sum(float v) {
#pragma unroll
    for (int o = 1; o < 64; o <<= 1) v += __shfl_xor(v, o);
    return v;
}

namespace pg8 {
constexpr int BM = 256, BK = 64, HALF = 128, HTB = HALF * BK * 2, STAGE_BYTES = 8 * HTB, NXCD = 8, WGM = 8;
__host__ __device__ __forceinline__ int lds_byte(int r, int c) { const int st = (r >> 4) * 2 + (c >> 5), rr = r & 15, cc = c & 31, ob = rr * 64 + cc * 2; return st * 1024 + (ob ^ (((ob >> 9) & 1) << 5)); }
__host__ __device__ __forceinline__ void stage_rc(int b, int& R, int& C) { const int st = b / 1024, sb = b % 1024, swz = sb ^ (((sb >> 9) & 1) << 5); R = (st >> 1) * 16 + swz / 64; C = (st & 1) * 32 + (swz % 64) / 2; }
__host__ __device__ __forceinline__ int perm32(int rho) { const int n = rho >> 4, i = rho & 15; return 8 * (i >> 2) + 4 * n + (i & 3); }

struct Unit { int pm, pn, a0, a1; };
struct Gemm { const bf16_t* A; const bf16_t* Bt; int K; const int* toks; };

struct StaticOrder {
    int nM, nN, nwg, G, c;
    __device__ void init(int M, int N, int G_, int c_) { nM = M / BM; nN = N / BM; nwg = nM * nN; G = G_; c = c_; }
    __device__ bool next(int i, Unit& u) const {
        const long L = (long)i * G + c; if (L >= nwg) return false;
        int wgid = (int)L; { const int q = nwg / NXCD, r = nwg % NXCD, xcd = wgid % NXCD, off = wgid / NXCD; wgid = (xcd < r ? xcd * (q + 1) : r * (q + 1) + (xcd - r) * q) + off; }
        const int nig = WGM * nN, gid = wgid / nig, fm = gid * WGM, gsz = (nM - fm) < WGM ? (nM - fm) : WGM;
        u.pm = fm + ((wgid % nig) % gsz); u.pn = (wgid % nig) / gsz; u.a0 = 0; u.a1 = 256; return true;
    }
};
struct GroupOrder {
    const volatile LAS int* tab;
    const volatile LAS int* cnt;
    int MT, NT, G, c;
    __device__ bool next(int i, Unit& u) const {
        const int L = i * G + c; if (L >= MT * NT) return false;
        const int mt = L / NT, t = L - mt * NT; const int e = tab[2 * mt], l = tab[2 * mt + 1];
        u.pm = mt; u.pn = e * NT + t; u.a0 = e * NTOK + l * 256; int v = cnt[e] - l * 256; u.a1 = v > 256 ? 256 : v; return true;
    }
};

struct EpiQKV {
    static constexpr bool PERM = true;
    bf16_t *QA, *KA, *VA, *QR, *KR, *VR, *G; const float *C64, *S64, *C128, *S128;
    __device__ __forceinline__ void operator()(const f32x4 (&acc)[2][2][4][2], const Unit& u, int wr, int wc, int fr, int fq) const {
        const int pn = u.pn, row0 = u.pm * BM + wr * 64 + fr;
        if (pn < 8) {
            bf16_t* dst = pn < 4 ? QA : KA; const int g = (pn & 3) * 4 + wc, h = g >> 1, comp = g & 1;
#pragma unroll
            for (int ai = 0; ai < 2; ++ai)
#pragma unroll
                for (int m = 0; m < 4; ++m) { int row = row0 + ai * HALF + m * 16; asm volatile("" : "+v"(row)); const int b = row >> 11, s = row & 2047;
                    const float* cp = C64 + (size_t)row * 32 + 8 * fq; const float* sp = S64 + (size_t)row * 32 + 8 * fq;
                    const f32x4 c0 = *(const f32x4*)cp, c1 = *(const f32x4*)(cp + 4), s0 = *(const f32x4*)sp, s1 = *(const f32x4*)(sp + 4);
                    const f32x4 a0 = acc[ai][0][m][0], a1 = acc[ai][0][m][1], b0 = acc[ai][1][m][0], b1 = acc[ai][1][m][1];
                    const f32x4 lo0 = a0 * c0 - b0 * s0, lo1 = a1 * c1 - b1 * s1, hi0 = b0 * c0 + a0 * s0, hi1 = b1 * c1 + a1 * s1;
                    bf16_t* d = dst + ((size_t)((b * 8 + h) * SEQ + s)) * 128 + comp * 64 + 8 * fq;
                    *(u32x4*)d = pack8f(lo0, lo1); *(u32x4*)(d + 32) = pack8f(hi0, hi1); asm volatile("" ::: "memory"); }
        } else if (pn < 12) {
#pragma unroll
            for (int ai = 0; ai < 2; ++ai)
#pragma unroll
                for (int m = 0; m < 4; ++m) { int row = row0 + ai * HALF + m * 16; asm volatile("" : "+v"(row)); const int b = row >> 11, s = row & 2047;
#pragma unroll
                    for (int bj = 0; bj < 2; ++bj) { const int h = (pn - 8) * 2 + bj;
                        *(u32x4*)(VA + ((size_t)((b * 8 + h) * SEQ + s)) * 128 + wc * 32 + 8 * fq) = pack8f(acc[ai][bj][m][0], acc[ai][bj][m][1]); } }
        } else if (pn < 16) {
            const bool isk = pn >= 14; bf16_t* dst = isk ? KR : QR; const int h = (pn & 1) * 2 + (wc >> 1), i0 = 32 * (wc & 1) + 8 * fq;
            const float lg2 = __builtin_log2f(1.0f - __builtin_exp2f(-5.0f - (float)h));
#pragma unroll
            for (int ai = 0; ai < 2; ++ai)
#pragma unroll
                for (int m = 0; m < 4; ++m) { int row = row0 + ai * HALF + m * 16; asm volatile("" : "+v"(row)); const int b = row >> 11, s = row & 2047;
                    const float sc = isk ? 0.08838834764831845f * __builtin_amdgcn_exp2f(-lg2 * (float)(s & 63)) : __builtin_amdgcn_exp2f(lg2 * (float)(s & 255));
                    const float* cp = C128 + (size_t)row * 64 + i0; const float* sp = S128 + (size_t)row * 64 + i0;
                    const f32x4 c0 = *(const f32x4*)cp, c1 = *(const f32x4*)(cp + 4), s0 = *(const f32x4*)sp, s1 = *(const f32x4*)(sp + 4);
                    const f32x4 a0 = acc[ai][0][m][0], a1 = acc[ai][0][m][1], b0 = acc[ai][1][m][0], b1 = acc[ai][1][m][1];
                    const f32x4 lo0 = (a0 * c0 - b0 * s0) * sc, lo1 = (a1 * c1 - b1 * s1) * sc, hi0 = (b0 * c0 + a0 * s0) * sc, hi1 = (b1 * c1 + a1 * s1) * sc;
                    bf16_t* d = dst + ((size_t)((b * 4 + h) * SEQ + s)) * 128 + i0;
                    *(u32x4*)d = pack8f(lo0, lo1); *(u32x4*)(d + 64) = pack8f(hi0, hi1); asm volatile("" ::: "memory"); }
        } else if (pn < 20) {
#pragma unroll
            for (int ai = 0; ai < 2; ++ai)
#pragma unroll
                for (int m = 0; m < 4; ++m) { int row = row0 + ai * HALF + m * 16; asm volatile("" : "+v"(row)); const int b = row >> 11, s = row & 2047;
#pragma unroll
                    for (int bj = 0; bj < 2; ++bj) { const int vh = (b * 4 + (pn - 16)) * 2 + bj;
                        *(u32x4*)(VR + ((size_t)(vh * SEQ + s)) * 128 + wc * 32 + 8 * fq) = pack8f(acc[ai][bj][m][0], acc[ai][bj][m][1]); } }
        } else {
#pragma unroll
            for (int ai = 0; ai < 2; ++ai)
#pragma unroll
                for (int m = 0; m < 4; ++m) { int row = row0 + ai * HALF + m * 16; asm volatile("" : "+v"(row));
#pragma unroll
                    for (int bj = 0; bj < 2; ++bj) { f32x4 v0 = acc[ai][bj][m][0], v1 = acc[ai][bj][m][1];
#pragma unroll
                        for (int j = 0; j < 4; ++j) { v0[j] = silu_f(v0[j]); v1[j] = silu_f(v1[j]); }
                        *(u32x4*)(G + (size_t)row * 1024 + (pn - 20) * 256 + bj * HALF + wc * 32 + 8 * fq) = pack8f(v0, v1); } }
        }
    }
};
struct EpiPlainBf16 {
    static constexpr bool PERM = true;
    bf16_t* O; int ldc;
    __device__ __forceinline__ void operator()(const f32x4 (&acc)[2][2][4][2], const Unit& u, int wr, int wc, int fr, int fq) const {
        const int row0 = u.pm * BM + wr * 64 + fr, col0 = u.pn * BM + wc * 32 + 8 * fq;
#pragma unroll
        for (int ai = 0; ai < 2; ++ai)
#pragma unroll
            for (int m = 0; m < 4; ++m) { bf16_t* rowp = O + (size_t)(row0 + ai * HALF + m * 16) * ldc + col0;
#pragma unroll
                for (int bj = 0; bj < 2; ++bj) *(u32x4*)(rowp + bj * HALF) = pack8f(acc[ai][bj][m][0], acc[ai][bj][m][1]); }
    }
};
struct EpiY1 {
    static constexpr bool PERM = false;
    const float* X; float* Y;
    __device__ __forceinline__ void operator()(const f32x4 (&acc)[2][2][4][2], const Unit& u, int wr, int wc, int fr, int fq) const {
        const int row0 = u.pm * BM + wr * 64 + fr, col0 = u.pn * BM + wc * 32 + 4 * fq;
#pragma unroll
        for (int ai = 0; ai < 2; ++ai)
#pragma unroll
            for (int m = 0; m < 4; ++m) { const size_t off = (size_t)(row0 + ai * HALF + m * 16) * DM + col0;
#pragma unroll
                for (int bj = 0; bj < 2; ++bj)
#pragma unroll
                    for (int n = 0; n < 2; ++n) { const f32x4 xv = *(const f32x4*)(X + off + bj * HALF + n * 16); *(f32x4*)(Y + off + bj * HALF + n * 16) = xv * ALPHA + acc[ai][bj][m][n]; } }
    }
};
struct EpiUp {
    static constexpr bool PERM = true;
    bf16_t* H;
    __device__ __forceinline__ void operator()(const f32x4 (&acc)[2][2][4][2], const Unit& u, int wr, int wc, int fr, int fq) const {
        const int row0 = u.pm * BM + wr * 64 + fr, col0 = (u.pn & 3) * 128 + wc * 32 + 8 * fq;
#pragma unroll
        for (int ai = 0; ai < 2; ++ai)
#pragma unroll
            for (int m = 0; m < 4; ++m) { f32x4 v0, v1;
#pragma unroll
                for (int j = 0; j < 4; ++j) { v0[j] = silu_f(acc[ai][0][m][0][j]) * acc[ai][1][m][0][j]; v1[j] = silu_f(acc[ai][0][m][1][j]) * acc[ai][1][m][1][j]; }
                *(u32x4*)(H + (size_t)(row0 + ai * HALF + m * 16) * FF + col0) = pack8f(v0, v1); }
    }
};
struct EpiDown {
    static constexpr bool PERM = true;
    bf16_t* Ys; const float* cw;
    __device__ __forceinline__ void operator()(const f32x4 (&acc)[2][2][4][2], const Unit& u, int wr, int wc, int fr, int fq) const {
        const int rl0 = wr * 64 + fr, col0 = (u.pn & 7) * BM + wc * 32 + 8 * fq;
#pragma unroll
        for (int ai = 0; ai < 2; ++ai)
#pragma unroll
            for (int m = 0; m < 4; ++m) { const int rl = rl0 + ai * HALF + m * 16; const float w = rl < u.a1 ? cw[u.a0 + rl] : 0.f;
                bf16_t* rowp = Ys + (size_t)(u.pm * BM + rl) * DM + col0;
#pragma unroll
                for (int bj = 0; bj < 2; ++bj) *(u32x4*)(rowp + bj * HALF) = pack8f(acc[ai][bj][m][0] * w, acc[ai][bj][m][1] * w); }
    }
};
struct EpiPle {
    static constexpr bool PERM = false;
    const float* X2; const bf16_t* G2; float* O;
    __device__ __forceinline__ void operator()(const f32x4 (&acc)[2][2][4][2], const Unit& u, int wr, int wc, int fr, int fq) const {
        const int row0 = u.pm * BM + wr * 64 + fr, col0 = u.pn * BM + wc * 32 + 4 * fq;
#pragma unroll
        for (int ai = 0; ai < 2; ++ai)
#pragma unroll
            for (int m = 0; m < 4; ++m) { const size_t off = (size_t)(row0 + ai * HALF + m * 16) * DM + col0;
#pragma unroll
                for (int bj = 0; bj < 2; ++bj)
#pragma unroll
                    for (int n = 0; n < 2; ++n) { const size_t o = off + bj * HALF + n * 16; const f32x4 xv = *(const f32x4*)(X2 + o); const u32x2 gw = *(const u32x2*)(G2 + o);
                        const f32x4 a = acc[ai][bj][m][n]; f32x4 r;
                        r[0] = xv[0] + sigmoid_f(a[0]) * bf_lo(gw.x); r[1] = xv[1] + sigmoid_f(a[1]) * bf_hi(gw.x); r[2] = xv[2] + sigmoid_f(a[2]) * bf_lo(gw.y); r[3] = xv[3] + sigmoid_f(a[3]) * bf_hi(gw.y);
                        *(f32x4*)(O + o) = r; } }
    }
};

template <class Epi, class Sched, bool ALIGN_EPI, bool GATHER>
__device__ __forceinline__ void gemm_phase(LAS unsigned char* lds, const Gemm g, const Sched& S, const Epi& E) {
    int tid = threadIdx.x; asm volatile("" : "+v"(tid));
    const int wid = __builtin_amdgcn_readfirstlane(tid >> 6), lane = tid & 63, wr = wid >> 2, wc = wid & 3, fr = lane & 15, fq = lane >> 4;
    const int K = g.K, nt = K / BK;
    unsigned voffA[2], voffB[2];
#pragma unroll
    for (int i = 0; i < 2; ++i) { int R, C; stage_rc(tid * 16 + i * 8192, R, C); const int Rb = Epi::PERM ? ((R & ~31) + perm32(R & 31)) : R; voffA[i] = (unsigned)(R * K + C) * 2u; voffB[i] = (unsigned)(Rb * K + C) * 2u; }
    const size_t kstep = (size_t)(BK * 2);
    const size_t hstep = (size_t)HALF * K * 2;
    const size_t tstep = 2 * hstep;
    const size_t ahs = GATHER ? 0 : hstep;
    const unsigned ldsw = (unsigned)wid * 1024u;
    const int aoff = lds_byte(wr * 64 + fr, fq * 8), boff = lds_byte(wc * 32 + fr, fq * 8);
#define PG8_SA(b, h) (((b) * 2 + (h)) * HTB)
#define PG8_SB(b, h) ((4 + (b) * 2 + (h)) * HTB)
#define PG8_STAGE2(bufoff, gbase, v0, v1) do { \
        __builtin_amdgcn_global_load_lds((const unsigned*)((const char*)(gbase) + (v0)), (LAS unsigned*)(lds + (bufoff) + ldsw), 16, 0, 0); \
        __builtin_amdgcn_global_load_lds((const unsigned*)((const char*)(gbase) + (v1)), (LAS unsigned*)(lds + (bufoff) + ldsw + 8192), 16, 0, 0); } while (0)
#define PG8_STAGEB(bufoff, gbase) PG8_STAGE2(bufoff, gbase, voffB[0], voffB[1])
#define PG8_LDA(dst, b, h) do { _Pragma("unroll") for (int m = 0; m < 4; ++m) _Pragma("unroll") for (int k = 0; k < 2; ++k) dst[m][k] = *(const LAS bf16x8*)(lds + PG8_SA(b, h) + aoff + m * 2048 + k * 1024); } while (0)
#define PG8_LDB(dst, b, h) do { _Pragma("unroll") for (int n = 0; n < 2; ++n) _Pragma("unroll") for (int k = 0; k < 2; ++k) dst[n][k] = *(const LAS bf16x8*)(lds + PG8_SB(b, h) + boff + n * 2048 + k * 1024); } while (0)
#define PG8_MMA(ai, bj, At, Bt) do { __builtin_amdgcn_s_setprio(1); _Pragma("unroll") for (int m = 0; m < 4; ++m) _Pragma("unroll") for (int n = 0; n < 2; ++n) _Pragma("unroll") for (int k = 0; k < 2; ++k) \
        acc[ai][bj][m][n] = __builtin_amdgcn_mfma_f32_16x16x32_bf16(Bt[n][k], At[m][k], acc[ai][bj][m][n], 0, 0, 0); __builtin_amdgcn_s_setprio(0); } while (0)
#define PG8_WAIT_V(n) asm volatile("s_waitcnt vmcnt(" #n ")" ::: "memory")
#define PG8_WAIT_L(n) asm volatile("s_waitcnt lgkmcnt(" #n ")" ::: "memory")
#define PG8_BAR __builtin_amdgcn_s_barrier()
#define PG8_SCHED __builtin_amdgcn_sched_barrier(0)
#define PG8_GOFFS(u, o00, o01, o10, o11) do { int R0, C0, R1, C1; stage_rc(tid * 16, R0, C0); stage_rc(tid * 16 + 8192, R1, C1); \
            const int r10 = HALF + R0, r11 = HALF + R1; \
            const int t00 = g.toks[(u).a0 + (R0 < (u).a1 ? R0 : 0)], t01 = g.toks[(u).a0 + (R1 < (u).a1 ? R1 : 0)], t10 = g.toks[(u).a0 + (r10 < (u).a1 ? r10 : 0)], t11 = g.toks[(u).a0 + (r11 < (u).a1 ? r11 : 0)]; \
            o00 = (unsigned)(t00 * K + C0) * 2u; o01 = (unsigned)(t01 * K + C1) * 2u; o10 = (unsigned)(t10 * K + C0) * 2u; o11 = (unsigned)(t11 * K + C1) * 2u; } while (0)
    Unit cur, nxt; int ui = 0;
    if (!S.next(0, cur)) return;
    f32x4 acc[2][2][4][2];
#pragma unroll
    for (int a = 0; a < 2; ++a)
#pragma unroll
        for (int b = 0; b < 2; ++b)
#pragma unroll
            for (int m = 0; m < 4; ++m)
#pragma unroll
                for (int n = 0; n < 2; ++n) acc[a][b][m][n] = (f32x4){0.f, 0.f, 0.f, 0.f};
    bf16x8 At[4][2], B0[2][2], B1[2][2];
    unsigned c00 = voffA[0], c01 = voffA[1], c10 = voffA[0], c11 = voffA[1], n00 = voffA[0], n01 = voffA[1], n10 = voffA[0], n11 = voffA[1];
    if constexpr (GATHER) { PG8_GOFFS(cur, c00, c01, c10, c11); }
    const char* cA = GATHER ? (const char*)g.A : (const char*)g.A + (size_t)cur.pm * tstep;
    const char* cB = (const char*)g.Bt + (size_t)cur.pn * tstep;
    PG8_STAGEB(PG8_SB(0, 0), cB); PG8_STAGEB(PG8_SB(0, 1), cB + hstep); PG8_STAGE2(PG8_SA(0, 0), cA, c00, c01); PG8_STAGE2(PG8_SA(0, 1), cA + ahs, c10, c11);
    if (wr == 1) PG8_BAR;
    PG8_WAIT_V(2); PG8_BAR;
    PG8_STAGEB(PG8_SB(1, 0), cB + kstep); PG8_STAGE2(PG8_SA(1, 0), cA + kstep, c00, c01); PG8_STAGEB(PG8_SB(1, 1), cB + hstep + kstep);
    PG8_WAIT_V(6); PG8_BAR;
    for (;;) {
        const bool has_next = S.next(ui + 1, nxt);
        if constexpr (GATHER) { if (has_next) { PG8_GOFFS(nxt, n00, n01, n10, n11); } else { n00 = c00; n01 = c01; n10 = c10; n11 = c11; } }
        const char* nA = GATHER ? cA : (has_next ? (const char*)g.A + (size_t)nxt.pm * tstep : cA);
        const char* nB = has_next ? (const char*)g.Bt + (size_t)nxt.pn * tstep : cB;
        for (int t = 0; t < nt; t += 2) {
            const bool last = (t == nt - 2);
            const char* a1 = cA + (size_t)(t + 1) * kstep;
            const char* a2 = last ? nA : cA + (size_t)(t + 2) * kstep; const char* b2 = last ? nB : cB + (size_t)(t + 2) * kstep;
            const char* a3 = a2 + kstep; const char* b3 = b2 + kstep;
            unsigned x00 = c00, x01 = c01, x10 = c10, x11 = c11;
            if constexpr (GATHER) { x00 = last ? n00 : c00; x01 = last ? n01 : c01; x10 = last ? n10 : c10; x11 = last ? n11 : c11; }
            PG8_LDB(B0, 0, 0); PG8_LDB(B1, 0, 1); PG8_SCHED; PG8_LDA(At, 0, 0); PG8_STAGE2(PG8_SA(1, 1), a1 + ahs, c10, c11);
            PG8_WAIT_V(8); PG8_WAIT_L(0); PG8_BAR; PG8_MMA(0, 0, At, B0); PG8_MMA(0, 1, At, B1); PG8_BAR; PG8_SCHED;
            PG8_LDA(At, 0, 1); PG8_STAGEB(PG8_SB(0, 0), b2); PG8_STAGEB(PG8_SB(0, 1), b2 + hstep); PG8_STAGE2(PG8_SA(0, 0), a2, x00, x01);
            PG8_WAIT_V(8); PG8_WAIT_L(0); PG8_BAR; PG8_MMA(1, 0, At, B0); PG8_MMA(1, 1, At, B1); PG8_BAR; PG8_SCHED;
            PG8_LDB(B0, 1, 0); PG8_LDB(B1, 1, 1); PG8_SCHED; PG8_LDA(At, 1, 0); PG8_STAGE2(PG8_SA(0, 1), a2 + ahs, x10, x11);
            PG8_WAIT_V(8); PG8_WAIT_L(0); PG8_BAR; PG8_MMA(0, 0, At, B0); PG8_MMA(0, 1, At, B1); PG8_BAR; PG8_SCHED;
            PG8_LDA(At, 1, 1); PG8_STAGEB(PG8_SB(1, 0), b3); PG8_STAGEB(PG8_SB(1, 1), b3 + hstep); PG8_STAGE2(PG8_SA(1, 0), a3, x00, x01);
            PG8_WAIT_V(8); PG8_WAIT_L(0); PG8_BAR; PG8_MMA(1, 0, At, B0); PG8_MMA(1, 1, At, B1); PG8_BAR; PG8_SCHED;
        }
        if constexpr (ALIGN_EPI) { if (wr == 0) PG8_BAR; }
        E(acc, cur, wr, wc, fr, fq);
        if (!has_next) break;
#pragma unroll
        for (int a = 0; a < 2; ++a)
#pragma unroll
            for (int b = 0; b < 2; ++b)
#pragma unroll
                for (int m = 0; m < 4; ++m)
#pragma unroll
                    for (int n = 0; n < 2; ++n) acc[a][b][m][n] = (f32x4){0.f, 0.f, 0.f, 0.f};
        cur = nxt; cA = nA; cB = nB; ++ui;
        if constexpr (GATHER) { c00 = n00; c01 = n01; c10 = n10; c11 = n11; }
        if constexpr (ALIGN_EPI) { if (wr == 1) PG8_BAR; }
    }
    PG8_WAIT_V(0);
    if constexpr (!ALIGN_EPI) { if (wr == 0) PG8_BAR; }
    PG8_BAR;
#undef PG8_SA
#undef PG8_SB
#undef PG8_STAGE2
#undef PG8_STAGEB
#undef PG8_LDA
#undef PG8_LDB
#undef PG8_MMA
#undef PG8_WAIT_V
#undef PG8_WAIT_L
#undef PG8_BAR
#undef PG8_SCHED
#undef PG8_GOFFS
}
}

namespace att {
constexpr int D = 128, NW = 8, QBLK = 32, KVBLK = 64, QB = NW * QBLK;
constexpr int SHM_V = KVBLK * D * 2, SHM_K = KVBLK * D * 2;
constexpr int LDS_BYTES = 2 * SHM_V + 2 * SHM_K + NW * 64 * 4;
constexpr float SCALE0 = 0.125f, THR = 8.f;
#define KSWZ(row, colB) ((row) * 256 + ((colB) ^ (((row) & 7) << 4)))
#define SBAR() __builtin_amdgcn_sched_barrier(0)
__device__ __forceinline__ int v_st(int k, int c) { const int kk = (k & ~0xC) | ((k & 4) << 1) | ((k & 8) >> 1); return ((kk >> 3) * 4 + (c >> 5)) * 512 + ((kk & 7) * 32 + (c & 31)) * 2; }
__device__ __forceinline__ int v_rd_base(int lane) { return ((lane & 3) << 3) | (((lane >> 2) & 3) << 6) | (((lane >> 4) & 1) << 5) | (((lane >> 5) & 1) << 8); }
constexpr int v_rd_off(int d0, int ks, int half) { return d0 * 512 + ks * 4096 + half * 2048; }
__device__ __forceinline__ int crow(int r, int hi) { return (r & 3) + 8 * (r >> 2) + 4 * hi; }
__device__ __forceinline__ bf16x8 load8(const bf16_t* p) { return *reinterpret_cast<const bf16x8*>(p); }

template <int MODE>
__device__ __forceinline__ void mask_tile(f32x16& p0, f32x16& p1, int dq) {
    const float NEG = MODE == 0 ? -__builtin_inff() : 0.f;
#pragma unroll
    for (int r = 0; r < 16; ++r) {
        const int c = (r & 3) + 8 * (r >> 2);
        if (dq - c < 0) p0[r] = NEG;
        if (dq - c - 32 < 0) p1[r] = NEG;
    }
}
__device__ __forceinline__ void partialSM(f32x16& p0, f32x16& p1, float& m_reg, float& mn, float& alpha) {
    float pmax = p0[0]; for (int r = 1; r < 16; ++r) pmax = fmaxf(pmax, p0[r]); for (int r = 0; r < 16; ++r) pmax = fmaxf(pmax, p1[r]);
    { auto rr = __builtin_amdgcn_permlane32_swap(__float_as_uint(pmax), __float_as_uint(pmax), false, false);
      pmax = fmaxf(__uint_as_float(rr[0]), __uint_as_float(rr[1])); }
    constexpr float C2 = 1.4426950408889634f * SCALE0;
    if (__builtin_expect(__all((pmax - m_reg) * SCALE0 <= THR), 1)) { mn = m_reg; alpha = 1.f; }
    else { mn = fmaxf(m_reg, pmax); alpha = __builtin_amdgcn_exp2f((m_reg - mn) * C2); m_reg = mn; }
    const float mnL = -mn * C2;
    for (int r = 0; r < 16; ++r) p0[r] = fmaf(p0[r], C2, mnL); for (int r = 0; r < 16; ++r) p1[r] = fmaf(p1[r], C2, mnL);
    for (int r = 0; r < 16; ++r) p0[r] = __builtin_amdgcn_exp2f(p0[r]);
}
#define PK4(P, B_, OUT) do { unsigned a0 = cvt_pk_bf16(P[B_+0], P[B_+1]), a1 = cvt_pk_bf16(P[B_+2], P[B_+3]);                          \
        unsigned b0 = cvt_pk_bf16(P[B_+4], P[B_+5]), b1 = cvt_pk_bf16(P[B_+6], P[B_+7]);                                             \
        auto r0 = __builtin_amdgcn_permlane32_swap(a0, b0, false, false); auto r1 = __builtin_amdgcn_permlane32_swap(a1, b1, false, false); \
        u32x4 w = {r0[0], r1[0], r0[1], r1[1]}; OUT = *reinterpret_cast<bf16x8*>(&w); } while (0)
__device__ __forceinline__ void finishSM(f32x16& p0, f32x16& p1, float alpha, float& l_reg, bf16x8& pa0, bf16x8& pa1, bf16x8& pa2, bf16x8& pa3) {
    for (int r = 0; r < 16; ++r) p1[r] = __builtin_amdgcn_exp2f(p1[r]);
    float ps = 0; for (int r = 0; r < 16; ++r) ps += p0[r]; for (int r = 0; r < 16; ++r) ps += p1[r];
    { auto rr = __builtin_amdgcn_permlane32_swap(__float_as_uint(ps), __float_as_uint(ps), false, false);
      ps = __uint_as_float(rr[0]) + __uint_as_float(rr[1]); }
    l_reg = l_reg * alpha + ps;
    PK4(p0, 0, pa0); PK4(p0, 8, pa1); PK4(p1, 0, pa2); PK4(p1, 8, pa3);
}
__device__ __forceinline__ void packP(f32x16& p0, f32x16& p1, bf16x8& pa0, bf16x8& pa1, bf16x8& pa2, bf16x8& pa3) {
    PK4(p0, 0, pa0); PK4(p0, 8, pa1); PK4(p1, 0, pa2); PK4(p1, 8, pa3);
}
#undef PK4
template <int KB, int MODE>
__device__ __forceinline__ void qkt(f32x16& p0, f32x16& p1, const char* K_lds, int r32, int hi, const bf16x8* qr, int kcoff) {
    p0 = f32x16{}; p1 = f32x16{};
    const char* kb[4];
#pragma unroll
    for (int dd = 0; dd < 4; ++dd) kb[dd] = K_lds + KB * SHM_K + KSWZ(r32, (dd * 16 + hi * 8) * 2) + kcoff;
    constexpr int ND = MODE == 0 ? 4 : 8;
#pragma unroll
    for (int d0 = 0; d0 < ND; ++d0) { const char* a = kb[d0 & 3] + (d0 >> 2) * 128;
        bf16x8 b0 = *reinterpret_cast<const bf16x8*>(a);
        bf16x8 b1 = *reinterpret_cast<const bf16x8*>(a + 32 * 256);
        p0 = __builtin_amdgcn_mfma_f32_32x32x16_bf16(b0, qr[d0], p0, 0, 0, 0);
        p1 = __builtin_amdgcn_mfma_f32_32x32x16_bf16(b1, qr[d0], p1, 0, 0, 0); }
}
template <int VB>
__device__ __forceinline__ void pv_tile(f32x16* o, int vb0, bf16x8 pa0, bf16x8 pa1, bf16x8 pa2, bf16x8 pa3) {
#define TRRD(dst, off) asm volatile("ds_read_b64_tr_b16 %0, %1 offset:%2" : "=&v"(dst) : "v"(vb0), "i"(off) : "memory")
#define PV_D0(d0) do { s16x4 l0, l1, l2, l3, h0, h1, h2, h3; constexpr int b_ = VB * SHM_V + v_rd_off(d0, 0, 0); \
        TRRD(l0, b_); TRRD(h0, b_ + 2048); TRRD(l1, b_ + 4096); TRRD(h1, b_ + 6144); TRRD(l2, b_ + 8192); TRRD(h2, b_ + 10240); TRRD(l3, b_ + 12288); TRRD(h3, b_ + 14336); \
        asm volatile("s_waitcnt lgkmcnt(0)" ::: "memory"); SBAR();   \
        o[d0] = __builtin_amdgcn_mfma_f32_32x32x16_bf16(pa0, (bf16x8){l0[0], l0[1], l0[2], l0[3], h0[0], h0[1], h0[2], h0[3]}, o[d0], 0, 0, 0);   \
        o[d0] = __builtin_amdgcn_mfma_f32_32x32x16_bf16(pa1, (bf16x8){l1[0], l1[1], l1[2], l1[3], h1[0], h1[1], h1[2], h1[3]}, o[d0], 0, 0, 0);   \
        o[d0] = __builtin_amdgcn_mfma_f32_32x32x16_bf16(pa2, (bf16x8){l2[0], l2[1], l2[2], l2[3], h2[0], h2[1], h2[2], h2[3]}, o[d0], 0, 0, 0);   \
        o[d0] = __builtin_amdgcn_mfma_f32_32x32x16_bf16(pa3, (bf16x8){l3[0], l3[1], l3[2], l3[3], h3[0], h3[1], h3[2], h3[3]}, o[d0], 0, 0, 0); } while (0)
    PV_D0(0); PV_D0(1); PV_D0(2); PV_D0(3);
#undef PV_D0
#undef TRRD
}
struct BlockRef { const bf16_t* Q; const bf16_t* K; const bf16_t* V; bf16_t* O; int P0; int kcoff; float lg2; };
struct Seam { bf16x8 qr[8]; bf16x8 st_v0, st_v1, st_k0, st_k1; };
#define ROW(p, k0, rr) ((p) + (size_t)((k0) + (rr)) * D + sc)
#define VMW() asm volatile("s_waitcnt vmcnt(0)" ::: "memory")
#define VMWN(n) asm volatile("s_waitcnt vmcnt(%0)" :: "i"(n) : "memory")
#define SLOAD_H(Kp, Vp, k0) do { S.st_v0 = load8(ROW(Vp, k0, sr)); S.st_v1 = load8(ROW(Vp, k0, 32 + sr));              \
                         S.st_k0 = load8(ROW(Kp, k0, sr)); S.st_k1 = load8(ROW(Kp, k0, 32 + sr)); } while (0)
#define SWRITE_HK(bf) do { *(bf16x8*)(K_lds + (bf) * SHM_K + kws) = S.st_k0; *(bf16x8*)(K_lds + (bf) * SHM_K + kws + 32 * 256) = S.st_k1; } while (0)
#define SWRITE_HV(bf) do { *(bf16x8*)(V_lds + (bf) * SHM_V + vst0) = S.st_v0; *(bf16x8*)(V_lds + (bf) * SHM_V + vst1) = S.st_v1; } while (0)
#define SWRITE_H(bf) do { SWRITE_HV(bf); SWRITE_HK(bf); } while (0)
template <int MODE>
__device__ __forceinline__ void attn_prime(const BlockRef& cur, char* lds, Seam& S) {
    constexpr int NQF = MODE == 0 ? 4 : 8;
    const int tid = threadIdx.x, wid = __builtin_amdgcn_readfirstlane(tid >> 6), lane = tid & 63, r32 = lane & 31, hi = lane >> 5;
    const int sr = tid >> 4, sc = (tid & 15) * 8, kws = KSWZ(sr, sc * 2); char* K_lds = lds + 2 * SHM_V;
#pragma unroll
    for (int d0 = 0; d0 < NQF; ++d0) S.qr[d0] = load8(cur.Q + (size_t)(wid * QBLK + r32) * D + d0 * 16 + hi * 8);
    SLOAD_H(cur.K, cur.V, 0); VMW(); SWRITE_HK(0);
    __syncthreads();
}
template <int MODE>
__device__ __forceinline__ void attn_block(const BlockRef& cur, const BlockRef& nxt, char* lds, Seam& S) {
    constexpr int NQF = MODE == 0 ? 4 : 8;
    const int tid = threadIdx.x, wid = __builtin_amdgcn_readfirstlane(tid >> 6), lane = tid & 63, r32 = lane & 31, hi = lane >> 5;
    const int NT = (cur.P0 + QB) / KVBLK;
    const int qlo = cur.P0 + wid * QBLK, qm = qlo + r32 - 4 * hi;
    char* V_lds = lds; char* K_lds = lds + 2 * SHM_V;
    float* ws = (float*)(lds + 2 * SHM_V + 2 * SHM_K) + wid * 64; float* li_l = ws, * al_l = ws + 32;
    float m_reg = -1e30f, l_reg = 0; f32x16 o[4] = {};
    const int sr = tid >> 4, sc = (tid & 15) * 8, vst0 = v_st(sr, sc), vst1 = v_st(32 + sr, sc), kws = KSWZ(sr, sc * 2);
    const int vb0 = (int)(uintptr_t)V_lds + v_rd_base(lane);
    const bf16_t* Kh = cur.K; const bf16_t* Vh = cur.V; const int kcoff = cur.kcoff;
#define RESC(a) do { if (__any((a) < 1.f)) { if (hi == 0) al_l[r32] = (a); asm volatile("s_waitcnt lgkmcnt(0)" ::: "memory");              \
                     for (int d_ = 0; d_ < 4; ++d_) for (int r = 0; r < 16; ++r) o[d_][r] *= al_l[crow(r, hi)]; } } while (0)
#define KBASE(t) ((t) * KVBLK)
#define MASKT(P0_, P1_, t) do { const int kb_ = KBASE(t); if (kb_ + KVBLK - 1 > qlo) mask_tile<MODE>(P0_, P1_, qm - kb_); } while (0)
#define PART(PX0, PX1, mnX, alX, t) do { if constexpr (MODE == 0) { partialSM(PX0, PX1, m_reg, mnX, alX); } \
        else { const float c_ = __builtin_amdgcn_exp2f(cur.lg2 * (float)(cur.P0 - KBASE(t))); for (int r = 0; r < 16; ++r) { PX0[r] *= c_; PX1[r] *= c_; } alX = 1.f; } } while (0)
#define FIN(PY0, PY1, alY) do { if constexpr (MODE == 0) finishSM(PY0, PY1, alY, l_reg, pa0, pa1, pa2, pa3); else packP(PY0, PY1, pa0, pa1, pa2, pa3); } while (0)
#define SEAM_K0() do { VMWN(NQF); SWRITE_HK(0); SBAR(); } while (0)
    f32x16 pA0, pA1, pB0, pB1; float mnA, mnB, alA, alB; bf16x8 pa0, pa1, pa2, pa3;
    SWRITE_HV(0); SBAR();
    if (NT > 1) { SLOAD_H(Kh, Vh, KBASE(1)); }
    SBAR(); qkt<0, MODE>(pA0, pA1, K_lds, r32, hi, S.qr, kcoff);
    MASKT(pA0, pA1, 0); PART(pA0, pA1, mnA, alA, 0);
    if (NT > 1) { VMW(); SWRITE_H(1); }
    __syncthreads();
#define HALF_STEP(PX0, PX1, mnX, alX, PY0, PY1, alY, t, KB, VB, SB) do {                                                      \
        SBAR(); qkt<KB, MODE>(PX0, PX1, K_lds, r32, hi, S.qr, kcoff);                                             \
        FIN(PY0, PY1, alY); SBAR();                                                           \
        if ((t) + 1 < NT) { SLOAD_H(Kh, Vh, KBASE((t) + 1)); SBAR(); }                                               \
        pv_tile<VB>(o, vb0, pa0, pa1, pa2, pa3); MASKT(PX0, PX1, (t)); PART(PX0, PX1, mnX, alX, (t));                                        \
        __syncthreads();                                                                                                      \
        if ((t) + 1 < NT) { VMW(); SWRITE_H(SB); }                                                                          \
        if constexpr (MODE == 0) { RESC(alX); } __syncthreads(); } while (0)
    for (int t = 1; t + 1 < NT; t += 2) {
        HALF_STEP(pB0, pB1, mnB, alB, pA0, pA1, alA, t, 1, 0, 0);
        HALF_STEP(pA0, pA1, mnA, alA, pB0, pB1, alB, t + 1, 0, 1, 1);
    }
    SBAR(); qkt<1, MODE>(pB0, pB1, K_lds, r32, hi, S.qr, kcoff); SBAR();
    SLOAD_H(nxt.K, nxt.V, 0); SBAR();
#pragma unroll
    for (int d0 = 0; d0 < NQF; ++d0) S.qr[d0] = load8(nxt.Q + (size_t)(wid * QBLK + r32) * D + d0 * 16 + hi * 8);
    SBAR();
    FIN(pA0, pA1, alA); SBAR();
    pv_tile<0>(o, vb0, pa0, pa1, pa2, pa3);
    MASKT(pB0, pB1, NT - 1); PART(pB0, pB1, mnB, alB, NT - 1); __syncthreads(); if constexpr (MODE == 0) { RESC(alB); }
    FIN(pB0, pB1, alB); SBAR(); pv_tile<1>(o, vb0, pa0, pa1, pa2, pa3);
    SBAR(); SEAM_K0();
    float rli[16];
    if constexpr (MODE == 0) {
        if (hi == 0) li_l[r32] = l_reg; asm volatile("s_waitcnt lgkmcnt(0)" ::: "memory");
#pragma unroll
        for (int r = 0; r < 16; ++r) rli[r] = __builtin_amdgcn_rcpf(li_l[crow(r, hi)]);
    } else {
#pragma unroll
        for (int r = 0; r < 16; ++r) rli[r] = 1.f;
    }
    bf16_t* Ow = cur.O + (size_t)(wid * QBLK) * D;
#pragma unroll
    for (int r = 0; r < 16; ++r) { const int orow = crow(r, hi);
#pragma unroll
        for (int d0 = 0; d0 < 4; ++d0) { const float v = o[d0][r] * rli[r];
            const float vn = __shfl_xor(v, 1);
            if ((r32 & 1) == 0) *(unsigned*)(Ow + (size_t)orow * D + d0 * 32 + r32) = cvt_pk_bf16(v, vn); } }
    __syncthreads();
#undef RESC
#undef KBASE
#undef MASKT
#undef PART
#undef FIN
#undef SEAM_K0
#undef HALF_STEP
}
#undef ROW
#undef VMW
#undef VMWN
#undef SLOAD_H
#undef SWRITE_HK
#undef SWRITE_HV
#undef SWRITE_H
#undef KSWZ
#undef SBAR
}

constexpr size_t MiB = 1u << 20;
constexpr size_t WS_CTL = 0, CTL_ZERO_BYTES = 1 * MiB;
constexpr size_t WS_TOK = 1 * MiB;
constexpr size_t WS_WIN = 2 * MiB;
constexpr size_t WS_WOUT = 26 * MiB;
constexpr size_t WS_WPG = 34 * MiB;
constexpr size_t WS_WPP = 42 * MiB;
constexpr size_t WS_C64 = 43 * MiB, WS_S64 = 44 * MiB, WS_C128 = 45 * MiB, WS_S128 = 47 * MiB;
constexpr size_t WS_CW = 49 * MiB;
constexpr size_t WS_WGU = 50 * MiB;
constexpr size_t WS_WD = 178 * MiB;
constexpr size_t WS_G2 = 242 * MiB;
constexpr size_t WS_XB = 274 * MiB;
constexpr size_t WS_PB = 306 * MiB;
constexpr size_t WS_QA = 310 * MiB, WS_KA = 342 * MiB, WS_VA = 374 * MiB, WS_QR = 390 * MiB, WS_KR = 398 * MiB, WS_VR = 406 * MiB, WS_G = 422 * MiB;
constexpr size_t WS_OA = 438 * MiB, WS_OR = 470 * MiB;
constexpr size_t WS_OC = 274 * MiB;
constexpr size_t WS_Y1 = 310 * MiB;
constexpr size_t WS_X1B = 374 * MiB;
constexpr size_t WS_H = 274 * MiB;
constexpr size_t WS_YS = 406 * MiB;
constexpr size_t WS_SEL = 502 * MiB;
constexpr size_t WS_WRT = 503 * MiB;
constexpr size_t WS_END = 512 * MiB;
constexpr int CW_TMO = 0;
constexpr int CW_BAR = 4096;
constexpr int CW_CNT = 16384;
constexpr int CW_AQ = 32768;
constexpr int RING_BYTES = 131072, MISC_OFF = RING_BYTES + 320, LDS_BYTES = 147456;
constexpr int NWAVES = 8;

#define XB_TMO      128
#define XB_XCNT(j)  (256  + 64 * (j))
#define XB_XSUB(j)  (1280 + 64 * (j))
#define XB_XGEN(j)  (2304 + 64 * (j))
#define XB_TOP      3328
#define XB_TOPGEN   3392
#define XCD_BAR_WORDS 3456
#define XB_SPIN_CAP (1u << 18)
__device__ __forceinline__ unsigned xb_ld(unsigned* p)              { return __hip_atomic_load(p, __ATOMIC_RELAXED, __HIP_MEMORY_SCOPE_AGENT); }
__device__ __forceinline__ unsigned xb_add(unsigned* p, unsigned v) { return __hip_atomic_fetch_add(p, v, __ATOMIC_RELAXED, __HIP_MEMORY_SCOPE_AGENT); }
__device__ __forceinline__ unsigned xb_xcc_id() { return (unsigned)__builtin_amdgcn_s_getreg((3 << 11) | 20) & 0xFu; }
#define XB_SPIN(cond, bar) do { unsigned _sp = 0; while (cond) { __builtin_amdgcn_s_sleep(1); \
    if ((++_sp & 255u) == 0u) { if (xb_ld(&(bar)[XB_TMO])) break; if (_sp > XB_SPIN_CAP) { atomicAdd(&(bar)[XB_TMO], 1u); break; } } } } while (0)
struct XcdBarrier { unsigned* bar; unsigned x; volatile LAS unsigned* st; };
__device__ __forceinline__ XcdBarrier xcd_barrier_post(unsigned* bar, volatile LAS unsigned* st) {
    XcdBarrier b; b.bar = bar; b.x = xb_xcc_id(); b.st = st;
    if (threadIdx.x == 0) (void)xb_add(&bar[XB_XCNT(b.x)], 1u);
    return b;
}
__device__ __forceinline__ void xcd_barrier_complete(unsigned* bar, unsigned x, unsigned& nloc, unsigned& nx) {
    const unsigned G = gridDim.x * gridDim.y * gridDim.z;
    unsigned sum, cnt, mine, sp = 0u;
    for (;;) {
        sum = 0u; cnt = 0u; mine = 0u;
#pragma unroll
        for (unsigned j = 0; j < 16; ++j) { const unsigned c = xb_ld(&bar[XB_XCNT(j)]); sum += c; cnt += (c > 0u) ? 1u : 0u; mine = (j == x) ? c : mine; }
        if (sum == G) break;
        __builtin_amdgcn_s_sleep(1);
        if ((++sp & 255u) == 0u) { if (xb_ld(&bar[XB_TMO])) break; if (sp > XB_SPIN_CAP) { atomicAdd(&bar[XB_TMO], 1u); break; } }
    }
    nloc = mine > 0u ? mine : 1u; nx = cnt > 0u ? cnt : 1u;
}
__device__ __forceinline__ void xcd_barrier(const XcdBarrier& b) {
    asm volatile("s_waitcnt vmcnt(0)" ::: "memory");
    __syncthreads();
    if (threadIdx.x == 0) {
        unsigned* bar = b.bar;
        __builtin_amdgcn_s_waitcnt(0);
        unsigned nloc = b.st[0], nx = b.st[1];
        if (nloc == 0u) { xcd_barrier_complete(bar, b.x, nloc, nx); b.st[0] = nloc; b.st[1] = nx; }
        const unsigned old = xb_add(&bar[XB_XSUB(b.x)], 1u);
        const unsigned gen = old / nloc;
        if (old + 1u == (gen + 1u) * nloc) {
            __builtin_amdgcn_fence(__ATOMIC_RELEASE, "agent");
            asm volatile("s_waitcnt vmcnt(0)" ::: "memory");
            const unsigned og = xb_add(&bar[XB_TOP], 1u);
            const unsigned tg = og / nx;
            if (og + 1u == (tg + 1u) * nx) xb_add(&bar[XB_TOPGEN], 1u);
            else XB_SPIN(xb_ld(&bar[XB_TOPGEN]) == tg, bar);
            __builtin_amdgcn_fence(__ATOMIC_ACQUIRE, "agent");
            xb_add(&bar[XB_XGEN(b.x)], 1u);
            asm volatile("s_waitcnt vmcnt(0)" ::: "memory");
        } else {
            XB_SPIN(xb_ld(&bar[XB_XGEN(b.x)]) == gen, bar);
            __builtin_amdgcn_fence(__ATOMIC_ACQUIRE, "agent");
            asm volatile("s_waitcnt vmcnt(0)" ::: "memory");
        }
    }
    __syncthreads();
}

struct Args { const void* in[23]; float* out; unsigned char* ws; int ph_lo, ph_hi; };
struct Frame {
    LAS unsigned char* lds; volatile LAS unsigned* MISC; unsigned* ctl; unsigned char* ws;
    int tid, lane, wave, vcu, G;
};
#define LDS_WAIT() asm volatile("s_waitcnt lgkmcnt(0)" ::: "memory")

__device__ __forceinline__ void p0_transpose_item(const float* W, int N, bf16_t* WT, int ldt, int drow0, LAS float* scr, int k0, int n0, int lane) {
#pragma unroll 8
    for (int i = 0; i < 32; ++i) { const int kk = 2 * i + (lane >> 5); scr[kk * 33 + (lane & 31)] = W[(size_t)(k0 + kk) * N + n0 + (lane & 31)]; }
    LDS_WAIT(); asm volatile("" ::: "memory");
    const int c = lane & 7;
#pragma unroll
    for (int j = 0; j < 4; ++j) { const int n = (lane >> 3) + 8 * j; const LAS float* s = scr + (8 * c) * 33 + n;
        u32x4 o; o.x = cvt_pk_bf16(s[0 * 33], s[1 * 33]); o.y = cvt_pk_bf16(s[2 * 33], s[3 * 33]); o.z = cvt_pk_bf16(s[4 * 33], s[5 * 33]); o.w = cvt_pk_bf16(s[6 * 33], s[7 * 33]);
        *(u32x4*)(WT + (size_t)(drow0 + n) * ldt + k0 + 8 * c) = o; }
    LDS_WAIT(); asm volatile("" ::: "memory");
}
__device__ __forceinline__ int perm_in(int n0) {
    if (n0 < 2048) return (n0 & ~255) + ((n0 >> 5) & 1) * 128 + ((n0 >> 6) & 3) * 32;
    if (n0 >= 3072 && n0 < 4096) return (n0 & ~255) + ((n0 >> 6) & 1) * 128 + ((n0 >> 7) & 1) * 64 + (n0 & 63);
    return n0;
}

__device__ __forceinline__ const void* gp(volatile LAS unsigned long long* P, int i) {
    const unsigned long long v = P[i]; const unsigned lo = __builtin_amdgcn_readfirstlane((unsigned)v), hi = __builtin_amdgcn_readfirstlane((unsigned)(v >> 32));
    return (const void*)(const GAS void*)(((unsigned long long)hi << 32) | lo); }
__device__ __forceinline__ att::BlockRef mk_da(int idx, const bf16_t* QA, const bf16_t* KA, const bf16_t* VA, bf16_t* OA) {
    att::BlockRef r; const int qb = 7 - (idx >> 6), vh = idx & 63, bh = vh >> 1, comp = vh & 1;
    r.Q = QA + ((size_t)bh * SEQ + qb * 256) * 128 + comp * 64; r.K = KA + (size_t)bh * SEQ * 128; r.V = VA + (size_t)bh * SEQ * 128;
    r.O = OA + ((size_t)vh * SEQ + qb * 256) * 128; r.P0 = qb * 256; r.kcoff = comp * 128; r.lg2 = 0.f; return r; }
__device__ __forceinline__ att::BlockRef mk_ret(int idx, const bf16_t* QR, const bf16_t* KR, const bf16_t* VR, bf16_t* ORt) {
    att::BlockRef r; const int qb = 7 - (idx >> 5), vh = idx & 31, bh = vh >> 1, h = bh & 3;
    r.Q = QR + ((size_t)bh * SEQ + qb * 256) * 128; r.K = KR + (size_t)bh * SEQ * 128; r.V = VR + (size_t)vh * SEQ * 128;
    r.O = ORt + ((size_t)vh * SEQ + qb * 256) * 128; r.P0 = qb * 256; r.kcoff = 0; r.lg2 = __builtin_log2f(1.0f - __builtin_exp2f(-5.0f - (float)h)); return r; }

__global__ void __launch_bounds__(NWAVES * 64, 2) hymba_fwd(Args args) {
    extern __shared__ __attribute__((aligned(16))) unsigned char lds_raw[];
    Frame F;
    F.lds = (LAS unsigned char*)lds_raw; F.MISC = (volatile LAS unsigned*)(F.lds + MISC_OFF);
    F.tid = threadIdx.x; F.lane = F.tid & 63; F.wave = __builtin_amdgcn_readfirstlane(F.tid >> 6);
    F.G = gridDim.x; { const int bx = blockIdx.x; F.vcu = (F.G % 8 == 0) ? (bx % 8) * (F.G / 8) + bx / 8 : bx; }
    F.ctl = (unsigned*)(args.ws + WS_CTL);
    for (int u = F.tid; u < (LDS_BYTES - RING_BYTES) / 4; u += NWAVES * 64) ((LAS unsigned*)(F.lds + RING_BYTES))[u] = 0u;
    __syncthreads();
    volatile LAS unsigned long long* PT = (volatile LAS unsigned long long*)(F.lds + MISC_OFF + 2048);
    if (F.tid == 0) {
        PT[0] = (unsigned long long)args.in[0]; PT[1] = (unsigned long long)args.in[1]; PT[2] = (unsigned long long)args.in[2]; PT[3] = (unsigned long long)args.in[3];
        PT[4] = (unsigned long long)args.in[4]; PT[5] = (unsigned long long)args.in[5]; PT[6] = (unsigned long long)args.in[6]; PT[7] = (unsigned long long)args.in[7];
        PT[8] = (unsigned long long)args.in[8]; PT[9] = (unsigned long long)args.in[9]; PT[10] = (unsigned long long)args.in[10]; PT[11] = (unsigned long long)args.in[11];
        PT[12] = (unsigned long long)args.in[12]; PT[13] = (unsigned long long)args.in[13]; PT[14] = (unsigned long long)args.in[14]; PT[15] = (unsigned long long)args.in[15];
        PT[16] = (unsigned long long)args.in[16]; PT[17] = (unsigned long long)args.in[17]; PT[18] = (unsigned long long)args.in[18]; PT[19] = (unsigned long long)args.in[19];
        PT[20] = (unsigned long long)args.in[20]; PT[21] = (unsigned long long)args.in[21]; PT[22] = (unsigned long long)args.in[22];
        PT[23] = (unsigned long long)args.out; PT[24] = (unsigned long long)args.ws; }
    __syncthreads();
#define LP(type, name, idx) type name = (type)gp(PT, idx)
#define LWS() unsigned char* ws = (unsigned char*)gp(PT, 24)
#define Win_t    ((bf16_t*)(ws + WS_WIN))
#define Wout_t   ((bf16_t*)(ws + WS_WOUT))
#define Wpg_t    ((bf16_t*)(ws + WS_WPG))
#define Wpp_t    ((bf16_t*)(ws + WS_WPP))
#define Wgu_t    ((bf16_t*)(ws + WS_WGU))
#define Wd_t     ((bf16_t*)(ws + WS_WD))
#define C64      ((float*)(ws + WS_C64))
#define S64      ((float*)(ws + WS_S64))
#define C128     ((float*)(ws + WS_C128))
#define S128     ((float*)(ws + WS_S128))
#define XB       ((bf16_t*)(ws + WS_XB))
#define PB       ((bf16_t*)(ws + WS_PB))
#define G2       ((bf16_t*)(ws + WS_G2))
#define QA       ((bf16_t*)(ws + WS_QA))
#define KA       ((bf16_t*)(ws + WS_KA))
#define VA       ((bf16_t*)(ws + WS_VA))
#define QR       ((bf16_t*)(ws + WS_QR))
#define KR       ((bf16_t*)(ws + WS_KR))
#define VR       ((bf16_t*)(ws + WS_VR))
#define GG       ((bf16_t*)(ws + WS_G))
#define OA       ((bf16_t*)(ws + WS_OA))
#define ORt      ((bf16_t*)(ws + WS_OR))
#define OC       ((bf16_t*)(ws + WS_OC))
#define Y1       ((float*)(ws + WS_Y1))
#define X1B      ((bf16_t*)(ws + WS_X1B))
#define HB       ((bf16_t*)(ws + WS_H))
#define YS       ((bf16_t*)(ws + WS_YS))
#define TOK      ((int*)(ws + WS_TOK))
#define CWL      ((float*)(ws + WS_CW))
#define SEL      ((int*)(ws + WS_SEL))
#define WRT      ((float*)(ws + WS_WRT))
    XcdBarrier bar; bar.bar = F.ctl + CW_BAR; bar.x = 0; bar.st = nullptr;
    if (MK_N_LAUNCHES == 1) bar = xcd_barrier_post(F.ctl + CW_BAR, F.MISC + 8);
#define GRID_BAR() do { if (MK_N_LAUNCHES == 1) xcd_barrier(bar); } while (0)
    const int lo = args.ph_lo, hi = args.ph_hi;
#ifndef PHASE_MASK
#define PHASE_MASK 0x3ff
#endif
#define IN(k) (((PHASE_MASK >> (k)) & 1) && lo <= (k) && (k) < hi)
#define BOTH(k) (IN(k) && IN((k) + 1))
    const int gw = F.vcu * NWAVES + F.wave, NGW = F.G * NWAVES;
    volatile LAS int* L_CNT = (volatile LAS int*)(F.MISC + 16); volatile LAS int* L_BASE = (volatile LAS int*)(F.MISC + 48); volatile LAS int* L_MT = (volatile LAS int*)(F.MISC + 80);
    volatile LAS int* L_TAB = (volatile LAS int*)(F.MISC + 96); volatile LAS int* L_Q = (volatile LAS int*)(F.MISC + 300);

    if (IN(0)) {
        LWS(); LP(const float*, x_, 0); LP(const float*, p_in_, 1); LP(const int*, positions_, 2); LP(const float*, w_in_, 3); LP(const float*, w_out_, 4);
        LP(const float*, w_rg_, 12); LP(const float*, w_re_, 14); LP(const float*, w_eg_, 16); LP(const float*, w_eu_, 17); LP(const float*, w_ed_, 18); LP(const float*, w_pg_, 21); LP(const float*, w_pp_, 22);
        LAS float* scr = (LAS float*)(F.lds + F.wave * 16384);
        constexpr int I_IN = 32 * 192, I_SQ = 32 * 64, I_PP = 4 * 64, I_EX = 32 * 32 * 16, I_ED = 32 * 8 * 64;
        constexpr int NITEMS = I_IN + 2 * I_SQ + I_PP + 2 * I_EX + I_ED;
        for (int it = gw; it < NITEMS; it += NGW) {
            int r = it;
            if (r < I_IN) { const int kb = r / 192, nb = r % 192; p0_transpose_item(w_in_, INW, Win_t, DM, perm_in(32 * nb), scr, 64 * kb, 32 * nb, F.lane); continue; } r -= I_IN;
            if (r < I_SQ) { const int kb = r / 64, nb = r % 64; p0_transpose_item(w_out_, DM, Wout_t, DM, 32 * nb, scr, 64 * kb, 32 * nb, F.lane); continue; } r -= I_SQ;
            if (r < I_SQ) { const int kb = r / 64, nb = r % 64; p0_transpose_item(w_pg_, DM, Wpg_t, DM, 32 * nb, scr, 64 * kb, 32 * nb, F.lane); continue; } r -= I_SQ;
            if (r < I_PP) { const int kb = r / 64, nb = r % 64; p0_transpose_item(w_pp_, DM, Wpp_t, PLED, 32 * nb, scr, 64 * kb, 32 * nb, F.lane); continue; } r -= I_PP;
            if (r < 2 * I_EX) { const int up = r >= I_EX; if (up) r -= I_EX; const int e = r / 512, q = r % 512, kb = q / 16, nb = q % 16, n0 = 32 * nb;
                p0_transpose_item((up ? w_eu_ : w_eg_) + (size_t)e * DM * FF, FF, Wgu_t, DM, e * 1024 + (n0 >> 7) * 256 + up * 128 + (n0 & 127), scr, 64 * kb, n0, F.lane); continue; } r -= 2 * I_EX;
            { const int e = r / 512, q = r % 512, kb = q / 64, nb = q % 64; p0_transpose_item(w_ed_ + (size_t)e * FF * DM, DM, Wd_t, FF, e * DM + 32 * nb, scr, 64 * kb, 32 * nb, F.lane); }
        }
        { const int gt = F.vcu * 512 + F.tid, NGT = F.G * 512;
          for (int i = gt; i < NTOK * DM / 8; i += NGT) { const f32x4 a = *(const f32x4*)(x_ + (size_t)i * 8), b = *(const f32x4*)(x_ + (size_t)i * 8 + 4); *(u32x4*)(XB + (size_t)i * 8) = pack8f(a, b); }
          for (int i = gt; i < NTOK * PLED / 8; i += NGT) { const f32x4 a = *(const f32x4*)(p_in_ + (size_t)i * 8), b = *(const f32x4*)(p_in_ + (size_t)i * 8 + 4); *(u32x4*)(PB + (size_t)i * 8) = pack8f(a, b); }
          for (int i = gt; i < NTOK * 96; i += NGT) { const int row = i / 96, j = i % 96; const float pos = (float)positions_[row];
              if (j < 32) { const float inv = powf(10000.0f, -(float)(2 * j) / 64.0f); float sn, cs; sincosf(pos * inv, &sn, &cs); C64[row * 32 + j] = cs; S64[row * 32 + j] = sn; }
              else { const int jj = j - 32; const float inv = powf(10000.0f, -(float)(2 * jj) / 128.0f); float sn, cs; sincosf(pos * inv, &sn, &cs); C128[row * 64 + jj] = cs; S128[row * 64 + jj] = sn; } }
          for (int i = gt; i < 36 * DM; i += NGT) { const int c = i / DM, k = i % DM; WRT[i] = c < 4 ? w_rg_[k * 4 + c] : w_re_[k * 32 + (c - 4)]; }
        }
        if (BOTH(0)) GRID_BAR();
    }

    if (IN(1)) {
        LWS();
        { pg8::Gemm g{XB, Win_t, DM, nullptr}; pg8::StaticOrder S; S.init(NTOK, INW, F.G, (int)blockIdx.x);
          pg8::EpiQKV E{QA, KA, VA, QR, KR, VR, GG, C64, S64, C128, S128};
          pg8::gemm_phase<pg8::EpiQKV, pg8::StaticOrder, true, false>(F.lds, g, S, E); }
        { pg8::Gemm g{PB, Wpp_t, PLED, nullptr}; pg8::StaticOrder S; S.init(NTOK, DM, F.G, (int)blockIdx.x);
          pg8::EpiPlainBf16 E{G2, DM};
          pg8::gemm_phase<pg8::EpiPlainBf16, pg8::StaticOrder, true, false>(F.lds, g, S, E); }
        if (BOTH(1)) GRID_BAR();
    }

    if (IN(2)) {
        LWS();
        char* alds = (char*)lds_raw;
        {
#define mk0(idx) mk_da(idx, QA, KA, VA, OA)
            unsigned* ctr = F.ctl + CW_AQ;
            if (F.tid == 0) { L_Q[0] = (int)xb_add(ctr, 1u); L_Q[1] = (int)xb_add(ctr, 1u); }
            __syncthreads();
            int ci = L_Q[0], ni = L_Q[1];
            if (ci < 512) {
                att::Seam S; att::BlockRef cur = mk0(ci);
                __syncthreads();
                att::attn_prime<0>(cur, alds, S);
                int par = 0;
                for (;;) {
                    if (F.tid == 0) L_Q[par] = (int)xb_add(ctr, 1u);
                    const bool hn = ni < 512; const att::BlockRef nxt = hn ? mk0(ni) : cur;
                    att::attn_block<0>(cur, nxt, alds, S);
                    if (!hn) break;
                    const int n2 = L_Q[par]; cur = nxt; ni = n2; par ^= 1;
                }
            }
            __syncthreads();
        }
        {
#define mk1(idx) mk_ret(idx, QR, KR, VR, ORt)
            unsigned* ctr = F.ctl + CW_AQ + 64;
            if (F.tid == 0) { L_Q[2] = (int)xb_add(ctr, 1u); L_Q[3] = (int)xb_add(ctr, 1u); }
            __syncthreads();
            int ci = L_Q[2], ni = L_Q[3];
            if (ci < 256) {
                att::Seam S; att::BlockRef cur = mk1(ci);
                __syncthreads();
                att::attn_prime<1>(cur, alds, S);
                int par = 0;
                for (;;) {
                    if (F.tid == 0) L_Q[2 + par] = (int)xb_add(ctr, 1u);
                    const bool hn = ni < 256; const att::BlockRef nxt = hn ? mk1(ni) : cur;
                    att::attn_block<1>(cur, nxt, alds, S);
                    if (!hn) break;
                    const int n2 = L_Q[2 + par]; cur = nxt; ni = n2; par ^= 1;
                }
            }
            __syncthreads();
        }
        if (BOTH(2)) GRID_BAR();
    }

    if (IN(3)) {
        LWS(); LP(const float*, lq1_, 5); LP(const float*, lk1_, 6); LP(const float*, lq2_, 7); LP(const float*, lk2_, 8); LP(const float*, subln_w_, 9);
        const float d1 = wave_sum(lq1_[F.lane] * lk1_[F.lane]), d2 = wave_sum(lq2_[F.lane] * lk2_[F.lane]);
        const float lam = expf(d1) - expf(d2) + LAM_INIT;
        const float sw0 = subln_w_[2 * F.lane] * (1.0f - LAM_INIT), sw1 = subln_w_[2 * F.lane + 1] * (1.0f - LAM_INIT);
        for (int row = gw; row < NTOK; row += NGW) { const int b = row >> 11, s = row & 2047;
#pragma unroll
            for (int h = 0; h < 8; ++h) { const int vh = (b * 8 + h) * 2;
                const unsigned w1 = *(const unsigned*)(OA + ((size_t)vh * SEQ + s) * 128 + 2 * F.lane), w2 = *(const unsigned*)(OA + ((size_t)(vh + 1) * SEQ + s) * 128 + 2 * F.lane);
                const float o0 = bf_lo(w1) - lam * bf_lo(w2), o1 = bf_hi(w1) - lam * bf_hi(w2);
                const float ms = wave_sum(o0 * o0 + o1 * o1) * (1.0f / 128.0f); const float r = 1.0f / sqrtf(ms + LN_EPS);
                *(unsigned*)(OC + (size_t)row * DM + h * 128 + 2 * F.lane) = cvt_pk_bf16(o0 * r * sw0, o1 * r * sw1); }
#pragma unroll
            for (int h = 0; h < 4; ++h) { const int vh = (b * 4 + h) * 2 + (F.lane >> 5);
                const u32x2 w = *(const u32x2*)(ORt + ((size_t)vh * SEQ + s) * 128 + 4 * (F.lane & 31));
                const float y0 = bf_lo(w.x), y1 = bf_hi(w.x), y2 = bf_lo(w.y), y3 = bf_hi(w.y);
                const float mu = wave_sum((y0 + y1) + (y2 + y3)) * (1.0f / 256.0f);
                const float e0 = y0 - mu, e1 = y1 - mu, e2 = y2 - mu, e3 = y3 - mu;
                const float var = wave_sum((e0 * e0 + e1 * e1) + (e2 * e2 + e3 * e3)) * (1.0f / 256.0f); const float r = 1.0f / sqrtf(var + LN_EPS);
                const u32x2 gg = *(const u32x2*)(GG + (size_t)row * 1024 + h * 256 + 4 * F.lane);
                u32x2 o; o.x = cvt_pk_bf16(bf_lo(gg.x) * e0 * r, bf_hi(gg.x) * e1 * r); o.y = cvt_pk_bf16(bf_lo(gg.y) * e2 * r, bf_hi(gg.y) * e3 * r);
                *(u32x2*)(OC + (size_t)row * DM + 1024 + h * 256 + 4 * F.lane) = o; }
        }
        if (BOTH(3)) GRID_BAR();
    }

    if (IN(4)) {
        LWS(); LP(const float*, x_, 0);
        pg8::Gemm g{OC, Wout_t, DM, nullptr}; pg8::StaticOrder S; S.init(NTOK, DM, F.G, (int)blockIdx.x);
        pg8::EpiY1 E{x_, Y1};
        pg8::gemm_phase<pg8::EpiY1, pg8::StaticOrder, true, false>(F.lds, g, S, E);
        if (BOTH(4)) GRID_BAR();
    }

    if (IN(5)) {
        LWS(); LP(const float*, ln1_g_, 10); LP(const float*, ln1_b_, 11); LP(const float*, b_rg_, 13); LP(const float*, b_re_, 15);
        LAS float* wl = (LAS float*)F.lds;
        const int rbase = F.vcu * 32 + F.wave * 4;
        for (int r0 = F.vcu * 32; r0 < NTOK; r0 += F.G * 32) {
            const int rw = r0 + F.wave * 4;
            f32x4 xv[4][8]; float lgt[4] = {0.f, 0.f, 0.f, 0.f};
#pragma unroll
            for (int i = 0; i < 4; ++i) { const int row = rw + i; float* yr = Y1 + (size_t)row * DM;
                float s = 0.f;
#pragma unroll
                for (int j = 0; j < 8; ++j) { xv[i][j] = *(const f32x4*)(yr + 256 * j + 4 * F.lane); s += (xv[i][j][0] + xv[i][j][1]) + (xv[i][j][2] + xv[i][j][3]); }
                const float mean = wave_sum(s) * (1.0f / DM); float s2 = 0.f;
#pragma unroll
                for (int j = 0; j < 8; ++j) { xv[i][j] = xv[i][j] - mean; s2 += (xv[i][j][0] * xv[i][j][0] + xv[i][j][1] * xv[i][j][1]) + (xv[i][j][2] * xv[i][j][2] + xv[i][j][3] * xv[i][j][3]); }
                const float rstd = 1.0f / sqrtf(wave_sum(s2) * (1.0f / DM) + LN_EPS);
#pragma unroll
                for (int j = 0; j < 8; ++j) { const f32x4 gv = *(const f32x4*)(ln1_g_ + 256 * j + 4 * F.lane), bv = *(const f32x4*)(ln1_b_ + 256 * j + 4 * F.lane);
                    xv[i][j] = xv[i][j] * rstd * gv + bv; *(f32x4*)(yr + 256 * j + 4 * F.lane) = xv[i][j];
                    u32x2 w; w.x = cvt_pk_bf16(xv[i][j][0], xv[i][j][1]); w.y = cvt_pk_bf16(xv[i][j][2], xv[i][j][3]); *(u32x2*)(X1B + (size_t)row * DM + 256 * j + 4 * F.lane) = w; }
            }
            for (int pass = 0; pass < 3; ++pass) {
                __syncthreads();
                for (int i = F.tid; i < 12 * DM / 4; i += 512) ((LAS f32x4*)wl)[i] = *(const f32x4*)(WRT + (size_t)pass * 12 * DM + 4 * i);
                __syncthreads();
#pragma unroll 1
                for (int c = 0; c < 12; ++c) {
                    f32x4 wv[8];
#pragma unroll
                    for (int j = 0; j < 8; ++j) wv[j] = *(const LAS f32x4*)(wl + c * DM + 256 * j + 4 * F.lane);
#pragma unroll
                    for (int i = 0; i < 4; ++i) { float a = 0.f;
#pragma unroll
                        for (int j = 0; j < 8; ++j) a += (xv[i][j][0] * wv[j][0] + xv[i][j][1] * wv[j][1]) + (xv[i][j][2] * wv[j][2] + xv[i][j][3] * wv[j][3]);
                        a = wave_sum(a); if (F.lane == pass * 12 + c) lgt[i] = a; }
                }
            }
            const float bias = F.lane < 4 ? b_rg_[F.lane] : (F.lane < 36 ? b_re_[F.lane - 4] : 0.f);
#pragma unroll
            for (int i = 0; i < 4; ++i) { const int row = rw + i; const float lg = lgt[i] + bias;
                float g0 = __shfl(lg, 0), g1 = __shfl(lg, 1), g2 = __shfl(lg, 2), g3 = __shfl(lg, 3);
                int gi = 0; float gm = g0; if (g1 > gm) { gm = g1; gi = 1; } if (g2 > gm) { gm = g2; gi = 2; } if (g3 > gm) { gm = g3; gi = 3; }
                const float gsum = expf(g0 - gm) + expf(g1 - gm) + expf(g2 - gm) + expf(g3 - gm); const float gwt = 1.0f / gsum;
                float ev[8];
#pragma unroll
                for (int j = 0; j < 8; ++j) ev[j] = __shfl(lg, 4 + gi * 8 + j);
                int i1 = 0; float v1 = ev[0];
#pragma unroll
                for (int j = 1; j < 8; ++j) if (ev[j] > v1) { v1 = ev[j]; i1 = j; }
                int i2 = -1; float v2 = -__builtin_inff();
#pragma unroll
                for (int j = 0; j < 8; ++j) if (j != i1 && ev[j] > v2) { v2 = ev[j]; i2 = j; }
                const float e2 = expf(v2 - v1); const float w1 = gwt / (1.0f + e2), w2 = gwt * e2 / (1.0f + e2);
                if (F.lane == 0) {
                    const int ea = gi * 8 + i1, eb = gi * 8 + i2;
                    const int pa = (int)xb_add(F.ctl + CW_CNT + 64 * ea, 1u), pb = (int)xb_add(F.ctl + CW_CNT + 64 * eb, 1u);
                    TOK[ea * NTOK + pa] = row; CWL[ea * NTOK + pa] = w1; TOK[eb * NTOK + pb] = row; CWL[eb * NTOK + pb] = w2;
                    SEL[row * 2] = (ea << 16) | pa; SEL[row * 2 + 1] = (eb << 16) | pb;
                }
            }
            (void)rbase;
        }
        __syncthreads();
        if (BOTH(5)) GRID_BAR();
    }

    if (hi > 6 && lo <= 8) {
        if (F.tid == 0) { int mt = 0;
            for (int e = 0; e < NEXP; ++e) { const int c = (int)xb_ld(F.ctl + CW_CNT + 64 * e); L_CNT[e] = c; L_BASE[e] = mt * 256; const int n = (c + 255) >> 8;
                for (int l = 0; l < n && mt < MAXMT; ++l) { L_TAB[2 * mt] = e; L_TAB[2 * mt + 1] = l; ++mt; } }
            L_MT[0] = mt; }
        __syncthreads();
    }

    if (IN(6)) {
        LWS();
        pg8::Gemm g{X1B, Wgu_t, DM, TOK}; pg8::GroupOrder S{L_TAB, L_CNT, L_MT[0], 4, F.G, F.vcu};
        pg8::EpiUp E{HB};
        pg8::gemm_phase<pg8::EpiUp, pg8::GroupOrder, true, true>(F.lds, g, S, E);
        if (BOTH(6)) GRID_BAR();
    }
    if (IN(7)) {
        LWS();
        pg8::Gemm g{HB, Wd_t, FF, nullptr}; pg8::GroupOrder S{L_TAB, L_CNT, L_MT[0], 8, F.G, F.vcu};
        pg8::EpiDown E{YS, CWL};
        pg8::gemm_phase<pg8::EpiDown, pg8::GroupOrder, true, false>(F.lds, g, S, E);
        if (BOTH(7)) GRID_BAR();
    }
    if (IN(8)) {
        LWS(); LP(const float*, ln2_g_, 19); LP(const float*, ln2_b_, 20);
        for (int row = gw; row < NTOK; row += NGW) {
            const int s0 = SEL[row * 2], s1 = SEL[row * 2 + 1];
            const size_t sl0 = (size_t)(L_BASE[s0 >> 16] + (s0 & 0xffff)), sl1 = (size_t)(L_BASE[s1 >> 16] + (s1 & 0xffff));
            float* yr = Y1 + (size_t)row * DM; f32x4 v[8]; float s = 0.f;
#pragma unroll
            for (int j = 0; j < 8; ++j) { const f32x4 xv = *(const f32x4*)(yr + 256 * j + 4 * F.lane);
                const u32x2 a = *(const u32x2*)(YS + sl0 * DM + 256 * j + 4 * F.lane), b = *(const u32x2*)(YS + sl1 * DM + 256 * j + 4 * F.lane);
                f32x4 m; m[0] = bf_lo(a.x) + bf_lo(b.x); m[1] = bf_hi(a.x) + bf_hi(b.x); m[2] = bf_lo(a.y) + bf_lo(b.y); m[3] = bf_hi(a.y) + bf_hi(b.y);
                v[j] = xv * ALPHA + m; s += (v[j][0] + v[j][1]) + (v[j][2] + v[j][3]); }
            const float mean = wave_sum(s) * (1.0f / DM); float s2 = 0.f;
#pragma unroll
            for (int j = 0; j < 8; ++j) { v[j] = v[j] - mean; s2 += (v[j][0] * v[j][0] + v[j][1] * v[j][1]) + (v[j][2] * v[j][2] + v[j][3] * v[j][3]); }
            const float rstd = 1.0f / sqrtf(wave_sum(s2) * (1.0f / DM) + LN_EPS);
#pragma unroll
            for (int j = 0; j < 8; ++j) { const f32x4 gv = *(const f32x4*)(ln2_g_ + 256 * j + 4 * F.lane), bv = *(const f32x4*)(ln2_b_ + 256 * j + 4 * F.lane);
                const f32x4 o = v[j] * rstd * gv + bv; *(f32x4*)(yr + 256 * j + 4 * F.lane) = o;
                u32x2 w; w.x = cvt_pk_bf16(o[0], o[1]); w.y = cvt_pk_bf16(o[2], o[3]); *(u32x2*)(X1B + (size_t)row * DM + 256 * j + 4 * F.lane) = w; }
        }
        if (BOTH(8)) GRID_BAR();
    }
    if (IN(9)) {
        LWS(); LP(float*, out_, 23);
        pg8::Gemm g{X1B, Wpg_t, DM, nullptr}; pg8::StaticOrder S; S.init(NTOK, DM, F.G, (int)blockIdx.x);
        pg8::EpiPle E{Y1, G2, out_};
        pg8::gemm_phase<pg8::EpiPle, pg8::StaticOrder, true, false>(F.lds, g, S, E);
    }
#undef IN
#undef BOTH
#undef GRID_BAR
}

#undef LP
#undef LWS
#undef Win_t
#undef Wout_t
#undef Wpg_t
#undef Wpp_t
#undef Wgu_t
#undef Wd_t
#undef C64
#undef S64
#undef C128
#undef S128
#undef XB
#undef PB
#undef G2
#undef QA
#undef KA
#undef VA
#undef QR
#undef KR
#undef VR
#undef GG
#undef OA
#undef ORt
#undef OC
#undef Y1
#undef X1B
#undef HB
#undef YS
#undef TOK
#undef CWL
#undef SEL
#undef WRT
#undef mk0
#undef mk1
extern "C" void kernel_launch(void* const* d_in, const int* in_sizes, int n_in, void* d_out, int out_size, void* d_ws, size_t ws_size, hipStream_t stream) {
    static int grid = 0;
    if (grid == 0) {
        if (n_in != 23 || in_sizes[0] != NTOK * DM || out_size != NTOK * DM || ws_size < WS_END) {
            fprintf(stderr, "kernel_launch: unexpected shapes (n_in %d, in0 %d, out %d, ws %zu; need ws >= %zu); nothing launched\n", n_in, n_in > 0 ? in_sizes[0] : -1, out_size, ws_size, (size_t)WS_END); grid = -1; return; }
        int dev = 0, cus = 0, per_cu = 0;
        if (hipGetDevice(&dev) != hipSuccess || hipDeviceGetAttribute(&cus, hipDeviceAttributeMultiprocessorCount, dev) != hipSuccess) { fprintf(stderr, "kernel_launch: device query failed\n"); grid = -1; return; }
        if (hipFuncSetAttribute((const void*)hymba_fwd, hipFuncAttributeMaxDynamicSharedMemorySize, LDS_BYTES) != hipSuccess) { fprintf(stderr, "kernel_launch: hipFuncSetAttribute failed\n"); grid = -1; return; }
        if (hipOccupancyMaxActiveBlocksPerMultiprocessor(&per_cu, (const void*)hymba_fwd, NWAVES * 64, LDS_BYTES) != hipSuccess || per_cu < 1) {
            fprintf(stderr, "kernel_launch: occupancy query reports %d workgroups per CU; need >= 1\n", per_cu); (void)hipGetLastError(); grid = -1; return; }
        (void)hipGetLastError();
        grid = cus;
        if (grid != 256) fprintf(stderr, "kernel_launch: note: %d CUs (built for 256)\n", grid);
    }
    if (grid < 0) return;
    (void)hipMemsetAsync((char*)d_ws + WS_CTL, 0, CTL_ZERO_BYTES, stream);
    Args a{};
    for (int i = 0; i < 23; ++i) a.in[i] = d_in[i];
    a.out = (float*)d_out; a.ws = (unsigned char*)d_ws;
#if MK_N_LAUNCHES == 1
    a.ph_lo = 0; a.ph_hi = NPHASE;
    hipLaunchKernelGGL(hymba_fwd, dim3(grid), dim3(NWAVES * 64), LDS_BYTES, stream, a);
#else
    for (int li = 0; li < NPHASE; ++li) { a.ph_lo = li; a.ph_hi = li + 1; hipLaunchKernelGGL(hymba_fwd, dim3(grid), dim3(NWAVES * 64), LDS_BYTES, stream, a); }
#endif
}
```
